# Optimizing an MI355X kernel written in HIP

```python
import math
import jax, jax.numpy as jnp
from jax import lax
import numpy as np

D_MODEL = 1024
BATCH = 1
SEQ = 16384
DEPTH = 1

HEAD_DIM = 64
D_ATTN = D_MODEL // 2
N_ATTN_HEADS = D_ATTN // HEAD_DIM
D_RNN = D_MODEL - D_ATTN
LRU_BLOCK = 64
N_LRU_BLOCKS = D_RNN // LRU_BLOCK
D_MIX = D_ATTN + D_RNN
D_IN_PROJ = 3 * D_ATTN + 2 * D_RNN
DILATED_PATTERNS = ((128, 1), (512, 4), (2048, 16))
ATTN_BLOCK = 128
CONV_WIDTH = 4
LRU_C = 8.0
D_FF = 2816
FFN_RES_WEIGHT = 0.5
N_SUBLAYERS = 3
RMS_EPS = 1e-6

kernel_name = "hybrid_dilated_attn_rglru_macaron_block"


def _rms(x):
    xf = x.astype(jnp.float32)
    return xf * lax.rsqrt(jnp.mean(xf * xf, axis=-1, keepdims=True) + RMS_EPS)


def _pre(x, g, shift, scale):
    return (_rms(x) * g * (1.0 + scale[:, None, :]) + shift[:, None, :]).astype(x.dtype)


def _post_residual(x, y, g, gate, weight):
    return x + (weight * (1.0 + gate[:, None, :]) * _rms(y) * g).astype(x.dtype)


def _swiglu(h, w_in, w_out):
    hg, hu = jnp.split(h @ w_in, 2, axis=-1)
    return (jax.nn.silu(hg) * hu) @ w_out


def _dilated_band(q, k, v, window, dilation):
    B, S, H, Dh = q.shape
    n_back = window // dilation
    chunk = dilation * ATTN_BLOCK
    s_pad = -(-S // chunk) * chunk
    L = s_pad // dilation
    nb = L // ATTN_BLOCK

    def to_strided(t):
        t = jnp.pad(t, ((0, 0), (0, s_pad - S), (0, 0), (0, 0)))
        t = t.reshape(B, L, dilation, H, Dh).transpose(0, 2, 1, 3, 4)
        return t.reshape(B, dilation, nb, ATTN_BLOCK, H, Dh)

    qs, ks, vs = to_strided(q), to_strided(k), to_strided(v)

    def with_prev(t):
        prev = jnp.pad(t[:, :, :-1], ((0, 0), (0, 0), (1, 0), (0, 0), (0, 0), (0, 0)))
        return jnp.concatenate([prev, t], axis=3)

    kk, vv = with_prev(ks), with_prev(vs)
    scores = jnp.einsum('brnqhd,brnkhd->brnhqk', qs, kk,
                        preferred_element_type=jnp.float32) * (Dh ** -0.5)
    qi = jnp.arange(ATTN_BLOCK)[:, None] + ATTN_BLOCK
    kj = jnp.arange(2 * ATTN_BLOCK)[None, :]
    dist = qi - kj
    band = (dist >= 0) & (dist <= n_back)
    has_prev = (jnp.arange(nb) > 0)[:, None, None] | (kj >= ATTN_BLOCK)[None]
    mask = (band[None] & has_prev)[:, None]
    scores = jnp.where(mask, scores, -jnp.inf)
    m = jnp.max(scores, axis=-1)
    p = jnp.exp(scores - m[..., None])
    l = jnp.sum(p, axis=-1)
    o = jnp.einsum('brnhqk,brnkhd->brnqhd', p, vv.astype(jnp.float32))

    def from_strided(t):
        X = t.shape[-1]
        t = t.reshape(B, dilation, L, H, X).transpose(0, 2, 1, 3, 4).reshape(B, s_pad, H, X)
        return t[:, :S]

    stats = from_strided(jnp.swapaxes(jnp.stack([m, l], axis=-1), 3, 4))
    return from_strided(o), stats[..., 0], stats[..., 1]


def _dilated_attention(q, k, v):
    res = [_dilated_band(q, k, v, w, d) for (w, d) in DILATED_PATTERNS]
    m_max = jnp.max(jnp.stack([r[1] for r in res]), axis=0)
    rescale = [jnp.exp(r[1] - m_max) for r in res]
    num = res[0][0] * rescale[0][..., None]
    den = res[0][2] * rescale[0]
    for r, s in zip(res[1:], rescale[1:]):
        num = num + r[0] * s[..., None]
        den = den + r[2] * s
    return num / den[..., None]


def _blockdiag(x, w):
    xb = x.reshape(x.shape[:-1] + (w.shape[0], w.shape[1]))
    return jnp.einsum('bsgi,gij->bsgj', xb, w).reshape(x.shape)


def _rg_lru(x, w_x, b_x, w_a, b_a, lam):
    f32 = jnp.float32
    xf = x.astype(f32)
    gate_x = jax.nn.sigmoid(_blockdiag(xf, w_x.astype(f32)) + b_x.astype(f32))
    gate_a = jax.nn.sigmoid(_blockdiag(xf, w_a.astype(f32)) + b_a.astype(f32))
    log_a = -LRU_C * gate_a * jax.nn.softplus(-lam.astype(f32))
    a = jnp.exp(log_a)
    b = xf * gate_x * jnp.sqrt(-jnp.expm1(2.0 * log_a))

    def combine(lhs, rhs):
        a_l, b_l = lhs
        a_r, b_r = rhs
        return a_l * a_r, a_r * b_l + b_r

    _, h = lax.associative_scan(combine, (a, b), axis=1)
    return h


def _hybrid_mixer(h, w_in, conv_w, conv_b, lru_w_x, lru_b_x, lru_w_a, lru_b_a, lru_lambda, w_out):
    B, S, _ = h.shape
    z = h @ w_in
    q, k, v, xr, gr = jnp.split(
        z, [D_ATTN, 2 * D_ATTN, 3 * D_ATTN, 3 * D_ATTN + D_RNN], axis=-1)
    heads = lambda t: t.reshape(B, S, N_ATTN_HEADS, HEAD_DIM)
    attn = _dilated_attention(heads(q), heads(k), heads(v)).reshape(B, S, D_ATTN)
    xr = lax.conv_general_dilated(
        xr, conv_w[:, None, :], window_strides=(1,), padding=[(CONV_WIDTH - 1, 0)],
        dimension_numbers=('NWC', 'WIO', 'NWC'), feature_group_count=D_RNN) + conv_b
    rec = _rg_lru(xr, lru_w_x, lru_b_x, lru_w_a, lru_b_a, lru_lambda) \
        * jax.nn.gelu(gr.astype(jnp.float32), approximate=True)
    mixed = jnp.concatenate([attn, rec], axis=-1).astype(h.dtype)
    return mixed @ w_out


def setup_inputs(seed: int = 0) -> dict:
    key = jax.random.key(seed)
    ks = jax.random.split(key, 20)
    f32 = jnp.float32
    nrm = lambda k, shape, fan_in: jax.random.normal(k, shape, f32) * (fan_in ** -0.5)
    u = jax.random.uniform(ks[17], (DEPTH, D_RNN), f32, minval=0.9, maxval=0.999)
    return {
        "x": jax.random.normal(ks[0], (BATCH, SEQ, D_MODEL), f32),
        "c": jax.random.normal(ks[1], (BATCH, D_MODEL), f32),
        "w_ada": 0.5 * nrm(ks[2], (DEPTH, D_MODEL, N_SUBLAYERS * 3 * D_MODEL), D_MODEL),
        "b_ada": 0.01 * jax.random.normal(ks[3], (DEPTH, N_SUBLAYERS * 3 * D_MODEL), f32),
        "norm_gain": 1.0 + 0.05 * jax.random.normal(ks[4], (DEPTH, 2 * N_SUBLAYERS, D_MODEL), f32),
        "ffn1_w_in": nrm(ks[5], (DEPTH, D_MODEL, 2 * D_FF), D_MODEL),
        "ffn1_w_out": nrm(ks[6], (DEPTH, D_FF, D_MODEL), D_FF),
        "mix_w_in": nrm(ks[7], (DEPTH, D_MODEL, D_IN_PROJ), D_MODEL),
        "conv_w": nrm(ks[8], (DEPTH, CONV_WIDTH, D_RNN), CONV_WIDTH),
        "conv_b": 0.01 * jax.random.normal(ks[9], (DEPTH, D_RNN), f32),
        "lru_w_x": nrm(ks[10], (DEPTH, N_LRU_BLOCKS, LRU_BLOCK, LRU_BLOCK), LRU_BLOCK),
        "lru_b_x": 0.01 * jax.random.normal(ks[11], (DEPTH, D_RNN), f32),
        "lru_w_a": nrm(ks[12], (DEPTH, N_LRU_BLOCKS, LRU_BLOCK, LRU_BLOCK), LRU_BLOCK),
        "lru_b_a": 0.01 * jax.random.normal(ks[13], (DEPTH, D_RNN), f32),
        "lru_lambda": jnp.log(u) - jnp.log1p(-u),
        "mix_w_out": nrm(ks[14], (DEPTH, D_MIX, D_MODEL), D_MIX),
        "ffn2_w_in": nrm(ks[15], (DEPTH, D_MODEL, 2 * D_FF), D_MODEL),
        "ffn2_w_out": nrm(ks[16], (DEPTH, D_FF, D_MODEL), D_FF),
    }


def reference(x, c, w_ada, b_ada, norm_gain, ffn1_w_in, ffn1_w_out, mix_w_in, conv_w, conv_b,
              lru_w_x, lru_b_x, lru_w_a, lru_b_a, lru_lambda, mix_w_out, ffn2_w_in, ffn2_w_out):
    f32 = jnp.float32
    B = x.shape[0]
    for l in range(DEPTH):
        mod = jax.nn.silu(c.astype(f32)) @ w_ada[l].astype(f32) + b_ada[l].astype(f32)
        mod = mod.reshape(B, N_SUBLAYERS, 3, D_MODEL)
        shift, scale, gate = mod[:, :, 0], mod[:, :, 1], mod[:, :, 2]
        g = norm_gain[l].astype(f32)

        h = _pre(x, g[0], shift[:, 0], scale[:, 0])
        y = _swiglu(h, ffn1_w_in[l], ffn1_w_out[l])
        x = _post_residual(x, y, g[1], gate[:, 0], FFN_RES_WEIGHT)

        h = _pre(x, g[2], shift[:, 1], scale[:, 1])
        y = _hybrid_mixer(h, mix_w_in[l], conv_w[l], conv_b[l], lru_w_x[l], lru_b_x[l],
                          lru_w_a[l], lru_b_a[l], lru_lambda[l], mix_w_out[l])
        x = _post_residual(x, y, g[3], gate[:, 1], 1.0)

        h = _pre(x, g[4], shift[:, 2], scale[:, 2])
        y = _swiglu(h, ffn2_w_in[l], ffn2_w_out[l])
        x = _post_residual(x, y, g[5], gate[:, 2], FFN_RES_WEIGHT)
    return x
```

```cpp
#include <hip/hip_runtime.h>
#include <cstdio>
#include <cstdint>

constexpr int S = 16384, D = 1024, DFF = 2816, DATT = 512, DRNN = 512, DIN = 2560, NH = 8, HD = 64;
constexpr float EPS = 1e-6f;

__device__ __forceinline__ float silu_f(float v) { return v / (1.f + __expf(-v)); }
__device__ __forceinline__ float sigmoid_f(float v) { return 1.f / (1.f + __expf(-v)); }
__device__ __forceinline__ float gelu_tanh_f(float v) { const float u = 0.7978845608028654f * (v + 0.044715f * v * v * v); return 0.5f * v * (1.f + tanhf(u)); }

__global__ void k_mod(const float* c, const float* w, const float* b, float* mod) {
    const int n = blockIdx.x * 256 + threadIdx.x;
    float acc = 0.f;
    for (int k = 0; k < D; ++k) acc += silu_f(c[k]) * w[(size_t)k * 9216 + n];
    mod[n] = acc + b[n];
}

__device__ __forceinline__ float block_sum256(float v, float* sh) {
    for (int o = 32; o > 0; o >>= 1) v += __shfl_xor(v, o);
    __syncthreads();
    if ((threadIdx.x & 63) == 0) sh[threadIdx.x >> 6] = v;
    __syncthreads();
    return sh[0] + sh[1] + sh[2] + sh[3];
}

__global__ void k_prenorm(const float* x, const float* g, const float* shift, const float* scale, float* out) {
    __shared__ float sh[4];
    const size_t row = blockIdx.x; const float* xr = x + row * D; float v[4]; float s = 0.f;
    for (int i = 0; i < 4; ++i) { v[i] = xr[threadIdx.x + 256 * i]; s += v[i] * v[i]; }
    const float tot = block_sum256(s, sh); const float r = rsqrtf(tot / D + EPS);
    for (int i = 0; i < 4; ++i) { const int c = threadIdx.x + 256 * i; out[row * D + c] = v[i] * r * g[c] * (1.f + scale[c]) + shift[c]; }
}
__global__ void k_post(const float* x, const float* y, const float* g, const float* gate, float w, float* out) {
    __shared__ float sh[4];
    const size_t row = blockIdx.x; const float* yr = y + row * D; float v[4]; float s = 0.f;
    for (int i = 0; i < 4; ++i) { v[i] = yr[threadIdx.x + 256 * i]; s += v[i] * v[i]; }
    const float tot = block_sum256(s, sh); const float r = rsqrtf(tot / D + EPS);
    for (int i = 0; i < 4; ++i) { const int c = threadIdx.x + 256 * i; out[row * D + c] = x[row * D + c] + w * (1.f + gate[c]) * (v[i] * r) * g[c]; }
}

__global__ void __launch_bounds__(256) k_gemm(const float* __restrict__ A, const float* __restrict__ B, float* __restrict__ C, int M, int N, int K) {
    __shared__ float As[16][65], Bs[16][64];
    const int tx = threadIdx.x & 15, ty = threadIdx.x >> 4, m0 = blockIdx.y * 64, n0 = blockIdx.x * 64;
    float acc[4][4] = {};
    for (int k0 = 0; k0 < K; k0 += 16) {
        for (int i = threadIdx.x; i < 1024; i += 256) { const int r = i >> 4, c = i & 15; As[c][r] = A[(size_t)(m0 + r) * K + k0 + c]; }
        for (int i = threadIdx.x; i < 1024; i += 256) { const int r = i >> 6, c = i & 63; Bs[r][c] = B[(size_t)(k0 + r) * N + n0 + c]; }
        __syncthreads();
#pragma unroll
        for (int kk = 0; kk < 16; ++kk) {
            float a[4], b[4];
#pragma unroll
            for (int i = 0; i < 4; ++i) { a[i] = As[kk][ty * 4 + i]; b[i] = Bs[kk][tx * 4 + i]; }
#pragma unroll
            for (int i = 0; i < 4; ++i)
#pragma unroll
                for (int j = 0; j < 4; ++j) acc[i][j] += a[i] * b[j];
        }
        __syncthreads();
    }
    for (int i = 0; i < 4; ++i) for (int j = 0; j < 4; ++j) C[(size_t)(m0 + ty * 4 + i) * N + n0 + tx * 4 + j] = acc[i][j];
}

__global__ void k_swiglu(const float* z, float* u, int rows) {
    const size_t i = (size_t)blockIdx.x * 256 + threadIdx.x; if (i >= (size_t)rows * DFF) return;
    const size_t m = i / DFF, j = i % DFF; u[i] = silu_f(z[m * 2 * DFF + j]) * z[m * 2 * DFF + DFF + j];
}

__global__ void __launch_bounds__(64) k_attn(const float* z, float* mixed) {
    __shared__ float sc[3 * 129 + 1]; __shared__ float qs[64];
    const int t = blockIdx.x, h = blockIdx.y, lane = threadIdx.x;
    const float* q = z + (size_t)t * DIN + h * HD; qs[lane] = q[lane]; __syncthreads();
    float mx = -INFINITY;
    for (int i = lane; i < 387; i += 64) {
        const int p = i / 129, j = i % 129, kp = t - j * (1 << (2 * p)); float s = -INFINITY;
        if (kp >= 0) { const float* kr = z + (size_t)kp * DIN + DATT + h * HD; float a = 0.f; for (int d = 0; d < 64; ++d) a += qs[d] * kr[d]; s = a * 0.125f; }
        sc[i] = s; mx = fmaxf(mx, s);
    }
    for (int o = 32; o > 0; o >>= 1) mx = fmaxf(mx, __shfl_xor(mx, o));
    __syncthreads();
    float l = 0.f, o = 0.f;
    for (int i = 0; i < 387; ++i) {
        const int p = i / 129, j = i % 129, kp = t - j * (1 << (2 * p)); if (kp < 0) continue;
        const float pr = __expf(sc[i] - mx); l += pr; o += pr * z[(size_t)kp * DIN + 2 * DATT + h * HD + lane];
    }
    mixed[(size_t)t * D + h * HD + lane] = o / l;
}

__global__ void __launch_bounds__(64) k_lru(const float* z, const float* conv_w, const float* conv_b, const float* wx, const float* bx, const float* wa, const float* ba, const float* lam, float* mixed) {
    const int g = blockIdx.x, j = threadIdx.x, c = g * 64 + j;
    __shared__ float xs[64];
    float wxc[64], wac[64];
#pragma unroll
    for (int i = 0; i < 64; ++i) { wxc[i] = wx[(size_t)g * 4096 + i * 64 + j]; wac[i] = wa[(size_t)g * 4096 + i * 64 + j]; }
    const float cw0 = conv_w[0 * DRNN + c], cw1 = conv_w[1 * DRNN + c], cw2 = conv_w[2 * DRNN + c], cw3 = conv_w[3 * DRNN + c], cb = conv_b[c];
    const float bxj = bx[c], baj = ba[c]; const float lm = lam[c]; const float sp = log1pf(__expf(-lm));
    float x0 = 0.f, x1 = 0.f, x2 = 0.f, h = 0.f;
    for (int t = 0; t < S; ++t) {
        const float x3 = z[(size_t)t * DIN + 3 * DATT + c];
        const float xc = cw0 * x0 + cw1 * x1 + cw2 * x2 + cw3 * x3 + cb; x0 = x1; x1 = x2; x2 = x3;
        __syncthreads(); xs[j] = xc; __syncthreads();
        float px = bxj, pa = baj;
#pragma unroll
        for (int i = 0; i < 64; ++i) { const float xi = xs[i]; px += xi * wxc[i]; pa += xi * wac[i]; }
        const float gx = sigmoid_f(px), ga = sigmoid_f(pa);
        const float log_a = -8.f * ga * sp; const float a = __expf(log_a); const float b = xc * gx * sqrtf(-expm1f(2.f * log_a));
        h = a * h + b;
        const float gr = z[(size_t)t * DIN + 3 * DATT + DRNN + c];
        mixed[(size_t)t * D + DATT + c] = h * gelu_tanh_f(gr);
    }
}

extern "C" void kernel_launch(void* const* d_in, const int* in_sizes, int n_in, void* d_out, int out_size, void* d_ws, size_t ws_size, hipStream_t stream) {
    const float* x = (const float*)d_in[0]; const float* c = (const float*)d_in[1]; const float* w_ada = (const float*)d_in[2]; const float* b_ada = (const float*)d_in[3];
    const float* gain = (const float*)d_in[4]; const float* f1_in = (const float*)d_in[5]; const float* f1_out = (const float*)d_in[6]; const float* mix_in = (const float*)d_in[7];
    const float* conv_w = (const float*)d_in[8]; const float* conv_b = (const float*)d_in[9]; const float* wx = (const float*)d_in[10]; const float* bx = (const float*)d_in[11];
    const float* wa = (const float*)d_in[12]; const float* ba = (const float*)d_in[13]; const float* lam = (const float*)d_in[14]; const float* mix_out = (const float*)d_in[15];
    const float* f2_in = (const float*)d_in[16]; const float* f2_out = (const float*)d_in[17];
    char* ws = (char*)d_ws; const size_t MB = 1u << 20;
    float* mod = (float*)ws; float* S0 = (float*)(ws + 1 * MB); float* S1 = (float*)(ws + 65 * MB); float* S2 = (float*)(ws + 129 * MB); float* T = (float*)(ws + 193 * MB); float* S3 = (float*)d_out;
    auto SH = [&](int s) { return mod + s * 3072; }; auto SC = [&](int s) { return mod + s * 3072 + 1024; }; auto GT = [&](int s) { return mod + s * 3072 + 2048; };
    k_mod<<<9216 / 256, 256, 0, stream>>>(c, w_ada, b_ada, mod);
    auto ffn = [&](const float* xin, float* H, float* Y, const float* w_in, const float* w_out) {
        constexpr int CH = 1024; float* zc = T; float* uc = T + (size_t)CH * 2 * DFF;
        for (int m0 = 0; m0 < S; m0 += CH) {
            k_gemm<<<dim3(2 * DFF / 64, CH / 64), 256, 0, stream>>>(H + (size_t)m0 * D, w_in, zc, CH, 2 * DFF, D);
            k_swiglu<<<(CH * DFF + 255) / 256, 256, 0, stream>>>(zc, uc, CH);
            k_gemm<<<dim3(D / 64, CH / 64), 256, 0, stream>>>(uc, w_out, Y + (size_t)m0 * D, CH, D, DFF);
        }
    };
    k_prenorm<<<S, 256, 0, stream>>>(x, gain + 0 * D, SH(0), SC(0), S1);
    ffn(x, S1, S2, f1_in, f1_out);
    k_post<<<S, 256, 0, stream>>>(x, S2, gain + 1 * D, GT(0), 0.5f, S0);
    k_prenorm<<<S, 256, 0, stream>>>(S0, gain + 2 * D, SH(1), SC(1), S3);
    float* Z = S1;
    k_gemm<<<dim3(DIN / 64, S / 64), 256, 0, stream>>>(S3, mix_in, Z, S, DIN, D);
    k_attn<<<dim3(S, NH), 64, 0, stream>>>(Z, S3);
    k_lru<<<8, 64, 0, stream>>>(Z, conv_w, conv_b, wx, bx, wa, ba, lam, S3);
    k_gemm<<<dim3(D / 64, S / 64), 256, 0, stream>>>(S3, mix_out, S1, S, D, D);
    k_post<<<S, 256, 0, stream>>>(S0, S1, gain + 3 * D, GT(1), 1.0f, S2);
    k_prenorm<<<S, 256, 0, stream>>>(S2, gain + 4 * D, SH(2), SC(2), S0);
    ffn(S2, S0, S1, f2_in, f2_out);
    k_post<<<S, 256, 0, stream>>>(S2, S1, gain + 5 * D, GT(2), 0.5f, (float*)d_out);
}
```
